# Optimizing an MI355X kernel written in HIP

```python
import math
import jax, jax.numpy as jnp
from jax import lax
import numpy as np

D_MODEL = 1024
BATCH = 16
SEQ = 2048
DEPTH = 2

CHUNK = 64
Q_BLOCK = 128
N_A_LAYERS = DEPTH // 2
N_B_LAYERS = DEPTH - N_A_LAYERS
A_HEADS = 8
A_HEAD_DIM = D_MODEL // (2 * A_HEADS)
B_HEADS = 16
B_HEAD_DIM = D_MODEL // B_HEADS
LEFT_CHUNKS = 8
BAND_CHUNKS = LEFT_CHUNKS + 1
MAX_REL_DIST = 256
D_FF = -(-8 * D_MODEL // (3 * 256)) * 256
ROPE_THETA = 10000.0
LN_EPS = 1e-5
SUBLN_EPS = 1e-5
DEEPNORM_ALPHA = (2 * DEPTH) ** 0.25
DEEPNORM_BETA = (8 * DEPTH) ** -0.25

kernel_name = "yoco_diffattn_chunkband_deepnorm"


def layer_norm(x, g, b):
    xf = x.astype(jnp.float32)
    mu = jnp.mean(xf, axis=-1, keepdims=True)
    var = jnp.mean(jnp.square(xf - mu), axis=-1, keepdims=True)
    y = (xf - mu) * lax.rsqrt(var + LN_EPS) * g.astype(jnp.float32) + b.astype(jnp.float32)
    return y.astype(x.dtype)


def rms_norm(x, g):
    xf = x.astype(jnp.float32)
    y = xf * lax.rsqrt(jnp.mean(jnp.square(xf), axis=-1, keepdims=True) + SUBLN_EPS)
    return (y * g.astype(jnp.float32)).astype(x.dtype)


def rope_tables(seq, dim):
    inv = ROPE_THETA ** (-jnp.arange(0, dim, 2, dtype=jnp.float32) / dim)
    ang = jnp.arange(seq, dtype=jnp.float32)[:, None] * inv[None, :]
    return jnp.cos(ang), jnp.sin(ang)


def apply_rope(x, cos, sin):
    half = x.shape[-1] // 2
    x1, x2 = x[..., :half], x[..., half:]
    cos = cos.astype(x.dtype)
    sin = sin.astype(x.dtype)
    return jnp.concatenate([x1 * cos - x2 * sin, x1 * sin + x2 * cos], axis=-1)


def lambda_init_fn(layer_idx):
    return 0.8 - 0.6 * math.exp(-0.3 * layer_idx)


def diff_attention(x, w_qkv, lam_params, subln_g, w_o, lambda_init):
    b, s, _ = x.shape
    qkv = x @ w_qkv
    q, k, v = jnp.split(qkv, 3, axis=-1)
    q = q.reshape(b, s, A_HEADS, 2, A_HEAD_DIM)
    k = k.reshape(b, s, A_HEADS, 2, A_HEAD_DIM)
    v = v.reshape(b, s, A_HEADS, 2 * A_HEAD_DIM)
    cos, sin = rope_tables(s, A_HEAD_DIM)
    cos = cos[:, None, None, :]
    sin = sin[:, None, None, :]
    q = apply_rope(q, cos, sin) * (A_HEAD_DIM ** -0.5)
    k = apply_rope(k, cos, sin)
    lp = lam_params.astype(jnp.float32)
    lam = jnp.exp(jnp.sum(lp[0] * lp[1])) - jnp.exp(jnp.sum(lp[2] * lp[3])) + lambda_init
    chunk_id = jnp.arange(s) // CHUNK
    neg = jnp.finfo(jnp.float32).min
    outs = []
    for i in range(s // Q_BLOCK):
        q0 = i * Q_BLOCK
        kend = q0 + Q_BLOCK
        sc = jnp.einsum('bqhmd,bkhmd->bhmqk', q[:, q0:kend], k[:, :kend],
                        preferred_element_type=jnp.float32)
        allowed = chunk_id[None, :kend] <= chunk_id[q0:kend, None]
        p = jax.nn.softmax(jnp.where(allowed, sc, neg), axis=-1)
        a = p[:, :, 0] - lam * p[:, :, 1]
        outs.append(jnp.einsum('bhqk,bkhe->bqhe', a.astype(v.dtype), v[:, :kend]))
    o = jnp.concatenate(outs, axis=1)
    o = rms_norm(o, subln_g) * (1.0 - lambda_init)
    return o.reshape(b, s, D_MODEL) @ w_o


def shared_kv_band(x, kv_w):
    b, s, _ = x.shape
    nc = s // CHUNK
    kv = x @ kv_w
    k, v = jnp.split(kv, 2, axis=-1)
    k = k.reshape(b, nc, CHUNK, B_HEADS, B_HEAD_DIM)
    v = v.reshape(b, nc, CHUNK, B_HEADS, B_HEAD_DIM)
    pad = ((0, 0), (LEFT_CHUNKS, 0), (0, 0), (0, 0), (0, 0))
    kp = jnp.pad(k, pad)
    vp = jnp.pad(v, pad)
    k_band = jnp.concatenate([kp[:, j:j + nc] for j in range(BAND_CHUNKS)], axis=2)
    v_band = jnp.concatenate([vp[:, j:j + nc] for j in range(BAND_CHUNKS)], axis=2)
    band_chunk = jnp.arange(BAND_CHUNKS * CHUNK) // CHUNK
    band_valid = (jnp.arange(nc)[:, None] - LEFT_CHUNKS + band_chunk[None, :]) >= 0
    return k_band, v_band, band_valid


def chunk_attention(x, k_band, v_band, band_valid, w_q, rel_table, w_o):
    b, s, _ = x.shape
    nc = s // CHUNK
    q = (x @ w_q).reshape(b, nc, CHUNK, B_HEADS, B_HEAD_DIM) * (B_HEAD_DIM ** -0.5)
    rel = (jnp.arange(BAND_CHUNKS * CHUNK)[None, :] - LEFT_CHUNKS * CHUNK
           - jnp.arange(CHUNK)[:, None])
    idx = jnp.clip(rel, -MAX_REL_DIST, MAX_REL_DIST) + MAX_REL_DIST
    bias = rel_table[:, idx].astype(jnp.float32)
    sc = jnp.einsum('bnqhd,bnkhd->bhnqk', q, k_band,
                    preferred_element_type=jnp.float32) + bias[:, None]
    sc = jnp.where(band_valid[:, None, :], sc, jnp.finfo(jnp.float32).min)
    p = jax.nn.softmax(sc, axis=-1)
    o = jnp.einsum('bhnqk,bnkhd->bnqhd', p.astype(v_band.dtype), v_band)
    return o.reshape(b, s, D_MODEL) @ w_o


def swiglu(x, w_in, w_out):
    gate, up = jnp.split(x @ w_in, 2, axis=-1)
    return (jax.nn.silu(gate) * up) @ w_out


def setup_inputs(seed: int = 0) -> dict:
    key = jax.random.key(seed)
    ks = jax.random.split(key, 14)
    f32 = jnp.float32
    d = D_MODEL
    nrm = lambda k, shape, sc: jax.random.normal(k, shape, f32) * sc
    return {
        "x": nrm(ks[0], (BATCH, SEQ, d), 1.0),
        "a_w_qkv": nrm(ks[1], (N_A_LAYERS, d, 3 * d), d ** -0.5),
        "a_lambda": nrm(ks[2], (N_A_LAYERS, 4, A_HEAD_DIM), 0.1),
        "a_subln_g": 1.0 + nrm(ks[3], (N_A_LAYERS, 2 * A_HEAD_DIM), 0.02),
        "a_w_o": nrm(ks[4], (N_A_LAYERS, d, d), d ** -0.5 * DEEPNORM_BETA),
        "kv_w": nrm(ks[5], (d, 2 * d), d ** -0.5),
        "b_w_q": nrm(ks[6], (N_B_LAYERS, d, d), d ** -0.5),
        "b_rel_bias": nrm(ks[7], (N_B_LAYERS, B_HEADS, 2 * MAX_REL_DIST + 1), 0.2),
        "b_w_o": nrm(ks[8], (N_B_LAYERS, d, d), d ** -0.5 * DEEPNORM_BETA),
        "ln_g": 1.0 + nrm(ks[9], (DEPTH, 2, d), 0.02),
        "ln_b": nrm(ks[10], (DEPTH, 2, d), 0.02),
        "ffn_w_in": nrm(ks[11], (DEPTH, d, 2 * D_FF), d ** -0.5),
        "ffn_w_out": nrm(ks[12], (DEPTH, D_FF, d), D_FF ** -0.5 * DEEPNORM_BETA),
    }


def reference(x, a_w_qkv, a_lambda, a_subln_g, a_w_o, kv_w, b_w_q, b_rel_bias, b_w_o,
              ln_g, ln_b, ffn_w_in, ffn_w_out):
    k_band = v_band = band_valid = None
    for l in range(DEPTH):
        if l < N_A_LAYERS:
            mix = diff_attention(x, a_w_qkv[l], a_lambda[l], a_subln_g[l], a_w_o[l],
                                 lambda_init_fn(l))
        else:
            if l == N_A_LAYERS:
                k_band, v_band, band_valid = shared_kv_band(x, kv_w)
            j = l - N_A_LAYERS
            mix = chunk_attention(x, k_band, v_band, band_valid, b_w_q[j], b_rel_bias[j], b_w_o[j])
        x = layer_norm(DEEPNORM_ALPHA * x + mix, ln_g[l, 0], ln_b[l, 0])
        x = layer_norm(DEEPNORM_ALPHA * x + swiglu(x, ffn_w_in[l], ffn_w_out[l]), ln_g[l, 1], ln_b[l, 1])
    return x
```

```cpp
#include <hip/hip_runtime.h>
#include <hip/hip_cooperative_groups.h>
#include <cstdio>
#include <cstdint>
namespace cg = cooperative_groups;
#ifndef MK_ONE_LAUNCH
#define MK_ONE_LAUNCH 0
#endif
namespace pg8 {
#define PG8_LAS __attribute__((address_space(3)))
typedef unsigned short bf16_t;
typedef short bf16x8 __attribute__((ext_vector_type(8)));
typedef float f32x4 __attribute__((ext_vector_type(4)));
typedef unsigned u32x4 __attribute__((ext_vector_type(4)));
constexpr int BM = 256, BK = 64, HALF = 128, HTB = HALF * BK * 2  , STAGE_BYTES = 8 * HTB, NXCD = 8, WGM = 8;

__host__ __device__ __forceinline__ int lds_byte(int r, int c) { const int st = (r >> 4) * 2 + (c >> 5), rr = r & 15, cc = c & 31, ob = rr * 64 + cc * 2; return st * 1024 + (ob ^ (((ob >> 9) & 1) << 5)); }
__host__ __device__ __forceinline__ void stage_rc(int b, int& R, int& C) { const int st = b / 1024, sb = b % 1024, swz = sb ^ (((sb >> 9) & 1) << 5); R = (st >> 1) * 16 + swz / 64; C = (st & 1) * 32 + (swz % 64) / 2; }
__host__ __device__ __forceinline__ int perm32(int rho) { const int n = rho >> 4, i = rho & 15; return 8 * (i >> 2) + 4 * n + (i & 3); }

struct Unit { int pm, pn; };
struct Gemm { const bf16_t* A; const bf16_t* Bt; int M, N, K; };

struct StaticOrder {
    int nM, nN, nwg, G, c;
    __host__ __device__ void init(int M, int N, int G_, int c_) { nM = M / BM; nN = N / BM; nwg = nM * nN; G = G_; c = c_; }
    __host__ __device__ bool next(int i, Unit& u) const {
        const long L = (long)i * G + c; if (L >= nwg) return false;
        int wgid = (int)L; { const int q = nwg / NXCD, r = nwg % NXCD, xcd = wgid % NXCD, off = wgid / NXCD; wgid = (xcd < r ? xcd * (q + 1) : r * (q + 1) + (xcd - r) * q) + off; }
        const int nig = WGM * nN, gid = wgid / nig, fm = gid * WGM, gsz = (nM - fm) < WGM ? (nM - fm) : WGM;
        u.pm = fm + ((wgid % nig) % gsz); u.pn = (wgid % nig) / gsz; return true;
    }
    __device__ __forceinline__ void a_ready(const Unit&) const {}
    __device__ __forceinline__ void done(const Unit&) const {}
};

__device__ __forceinline__ unsigned cvt_pk_bf16(float lo, float hi) { unsigned r; asm volatile("v_cvt_pk_bf16_f32 %0, %1, %2" : "=v"(r) : "v"(lo), "v"(hi)); return r; }
typedef float f32x2 __attribute__((ext_vector_type(2)));
typedef float f32x2 __attribute__((ext_vector_type(2)));
struct EpiPlain {
    static constexpr bool PERM = true, AFTER_DRAIN = false;
    bf16_t* O; int ldc; int scale_from; float scale;
    __device__ __forceinline__ void operator()(const f32x4 (&acc)[2][2][4][2], const Unit& u, int wr, int wc, int fr, int fq) const {
        const int row0 = u.pm * BM + wr * 64 + fr, colt = u.pn * BM; const float sc = (colt >= scale_from) ? scale : 1.f;
        const int col0 = colt + wc * 32 + 8 * fq;
#pragma unroll
        for (int ai = 0; ai < 2; ++ai)
#pragma unroll
            for (int m = 0; m < 4; ++m) { bf16_t* rowp = O + (size_t)(row0 + ai * HALF + m * 16) * ldc + col0;
#pragma unroll
                for (int bj = 0; bj < 2; ++bj) { const f32x4 v0 = acc[ai][bj][m][0] * sc, v1 = acc[ai][bj][m][1] * sc;
                    u32x4 w; w.x = cvt_pk_bf16(v0[0], v0[1]); w.y = cvt_pk_bf16(v0[2], v0[3]); w.z = cvt_pk_bf16(v1[0], v1[1]); w.w = cvt_pk_bf16(v1[2], v1[3]);
                    *(u32x4*)(rowp + bj * HALF) = w; } }
    }
};
struct EpiQkvRope {
    static constexpr bool PERM = true, AFTER_DRAIN = false;
    bf16_t* O; int ldc; const float* cs; float qscale;
    __device__ __forceinline__ void operator()(const f32x4 (&acc)[2][2][4][2], const Unit& u, int wr, int wc, int fr, int fq) const {
        const int row0 = u.pm * BM + wr * 64 + fr, colt = u.pn * BM;
        if (colt >= 2048) {
            const int col0 = colt + wc * 32 + 8 * fq;
#pragma unroll
            for (int ai = 0; ai < 2; ++ai)
#pragma unroll
                for (int m = 0; m < 4; ++m) { bf16_t* rowp = O + (size_t)(row0 + ai * HALF + m * 16) * ldc + col0;
#pragma unroll
                    for (int bj = 0; bj < 2; ++bj) { const f32x4 v0 = acc[ai][bj][m][0], v1 = acc[ai][bj][m][1];
                        u32x4 w; w.x = cvt_pk_bf16(v0[0], v0[1]); w.y = cvt_pk_bf16(v0[2], v0[3]); w.z = cvt_pk_bf16(v1[0], v1[1]); w.w = cvt_pk_bf16(v1[2], v1[3]);
                        *(u32x4*)(rowp + bj * HALF) = w; } }
        } else {
            const float sc = (colt < 1024) ? qscale : 1.f;
            const int colb = colt + 64 * wc + 8 * fq;
#pragma unroll
            for (int ai = 0; ai < 2; ++ai)
#pragma unroll
                for (int m = 0; m < 4; ++m) { const int row = row0 + ai * HALF + m * 16; const int pos = row & 2047;
                    const f32x4* cp = (const f32x4*)(cs + ((size_t)pos * 32 + 8 * fq) * 2);
                    const f32x4 t0 = cp[0], t1 = cp[1], t2 = cp[2], t3 = cp[3];
                    const f32x4 c0 = {t0[0], t0[2], t1[0], t1[2]}, s0 = {t0[1], t0[3], t1[1], t1[3]}, c1 = {t2[0], t2[2], t3[0], t3[2]}, s1 = {t2[1], t2[3], t3[1], t3[3]};
                    const f32x4 xa0 = acc[ai][0][m][0], xa1 = acc[ai][0][m][1], xb0 = acc[ai][1][m][0], xb1 = acc[ai][1][m][1];
                    const f32x4 o10 = (xa0 * c0 - xb0 * s0) * sc, o11 = (xa1 * c1 - xb1 * s1) * sc, o20 = (xa0 * s0 + xb0 * c0) * sc, o21 = (xa1 * s1 + xb1 * c1) * sc;
                    bf16_t* rowp = O + (size_t)row * ldc + colb;
                    u32x4 w; w.x = cvt_pk_bf16(o10[0], o10[1]); w.y = cvt_pk_bf16(o10[2], o10[3]); w.z = cvt_pk_bf16(o11[0], o11[1]); w.w = cvt_pk_bf16(o11[2], o11[3]);
                    *(u32x4*)(rowp) = w;
                    w.x = cvt_pk_bf16(o20[0], o20[1]); w.y = cvt_pk_bf16(o20[2], o20[3]); w.z = cvt_pk_bf16(o21[0], o21[1]); w.w = cvt_pk_bf16(o21[2], o21[3]);
                    *(u32x4*)(rowp + 32) = w; }
        }
    }
};
struct EpiResid {
    static constexpr bool PERM = true, AFTER_DRAIN = false;
    const float* base; float* out; int ldc; float alpha;
    __device__ __forceinline__ void operator()(const f32x4 (&acc)[2][2][4][2], const Unit& u, int wr, int wc, int fr, int fq) const {
        const int row0 = u.pm * BM + wr * 64 + fr, col0 = u.pn * BM + wc * 32 + 8 * fq;
#pragma unroll
        for (int ai = 0; ai < 2; ++ai)
#pragma unroll
            for (int m = 0; m < 4; ++m) { const size_t off = (size_t)(row0 + ai * HALF + m * 16) * ldc + col0;
#pragma unroll
                for (int bj = 0; bj < 2; ++bj)
#pragma unroll
                    for (int n = 0; n < 2; ++n) { const f32x4 b = *(const f32x4*)(base + off + bj * HALF + 4 * n); *(f32x4*)(out + off + bj * HALF + 4 * n) = b * alpha + acc[ai][bj][m][n]; } }
    }
};
struct EpiSwiglu {
    static constexpr bool PERM = true, AFTER_DRAIN = false;
    bf16_t* O; int ldc;
    __device__ __forceinline__ void operator()(const f32x4 (&acc)[2][2][4][2], const Unit& u, int wr, int wc, int fr, int fq) const {
        const int row0 = u.pm * BM + wr * 64 + fr, col0 = u.pn * HALF + wc * 32 + 8 * fq;
#pragma unroll
        for (int ai = 0; ai < 2; ++ai)
#pragma unroll
            for (int m = 0; m < 4; ++m) { float v[8];
#pragma unroll
                for (int n = 0; n < 2; ++n)
#pragma unroll
                    for (int i = 0; i < 4; ++i) { const float g = acc[ai][0][m][n][i], up = acc[ai][1][m][n][i];
                        v[4 * n + i] = g * up * __builtin_amdgcn_rcpf(1.0f + __builtin_amdgcn_exp2f(-1.4426950408889634f * g)); }
                u32x4 w; w.x = cvt_pk_bf16(v[0], v[1]); w.y = cvt_pk_bf16(v[2], v[3]); w.z = cvt_pk_bf16(v[4], v[5]); w.w = cvt_pk_bf16(v[6], v[7]);
                *(u32x4*)(O + (size_t)(row0 + ai * HALF + m * 16) * ldc + col0) = w; }
    }
};
template <class Epi, class Sched, bool ALIGN_EPI = false, bool SP2 = false>
__device__ __forceinline__ void gemm_phase(PG8_LAS unsigned char* lds, const Gemm g, const Sched& S, const Epi& E) {
    const int tid = threadIdx.x, wid = __builtin_amdgcn_readfirstlane(tid >> 6), lane = tid & 63, wr = wid >> 2, wc = wid & 3, fr = lane & 15, fq = lane >> 4;
    const int K = g.K, nt = K / BK;
    unsigned voffA[2], voffB[2];
#pragma unroll
    for (int i = 0; i < 2; ++i) { int R, C; stage_rc(tid * 16 + i * 8192, R, C); const int Rb = Epi::PERM ? ((R & ~31) + perm32(R & 31)) : R;
        voffA[i] = (unsigned)(R * K + C) * 2u; voffB[i] = (unsigned)(Rb * K + C) * 2u; }
    const size_t kstep = (size_t)(BK * 2);
    const size_t hstep = (size_t)HALF * K * 2;
    const size_t tstep = 2 * hstep;
    const unsigned ldsw = (unsigned)wid * 1024u;
    const int aoff = lds_byte(wr * 64 + fr, fq * 8), boff = lds_byte(wc * 32 + fr, fq * 8);
#define PG8_SA(b, h) (((b) * 2 + (h)) * HTB)
#define PG8_SB(b, h) ((4 + (b) * 2 + (h)) * HTB)
#define PG8_STAGE(bufoff, gbase, voff) do { _Pragma("unroll") for (int _i = 0; _i < 2; ++_i) \
        __builtin_amdgcn_global_load_lds((const unsigned*)((const char*)(gbase) + (voff)[_i]), (PG8_LAS unsigned*)(lds + (bufoff) + ldsw + _i * 8192), 16, 0, 0); } while (0)
#define PG8_LDA(dst, b, h) do { _Pragma("unroll") for (int m = 0; m < 4; ++m) _Pragma("unroll") for (int k = 0; k < 2; ++k) dst[m][k] = *(const PG8_LAS bf16x8*)(lds + PG8_SA(b, h) + aoff + m * 2048 + k * 1024); } while (0)
#define PG8_LDB(dst, b, h) do { _Pragma("unroll") for (int n = 0; n < 2; ++n) _Pragma("unroll") for (int k = 0; k < 2; ++k) dst[n][k] = *(const PG8_LAS bf16x8*)(lds + PG8_SB(b, h) + boff + n * 2048 + k * 1024); } while (0)
#define PG8_MMA(ai, bj, At, Bt) do { __builtin_amdgcn_s_setprio(1); _Pragma("unroll") for (int m = 0; m < 4; ++m) _Pragma("unroll") for (int n = 0; n < 2; ++n) _Pragma("unroll") for (int k = 0; k < 2; ++k) \
        acc[ai][bj][m][n] = __builtin_amdgcn_mfma_f32_16x16x32_bf16(Bt[n][k], At[m][k], acc[ai][bj][m][n], 0, 0, 0); __builtin_amdgcn_s_setprio(0); } while (0)
#define PG8_WAIT_V(n) asm volatile("s_waitcnt vmcnt(" #n ")" ::: "memory")
#define PG8_WAIT_L(n) asm volatile("s_waitcnt lgkmcnt(" #n ")" ::: "memory")
#define PG8_BAR __builtin_amdgcn_s_barrier()
#define PG8_SCHED __builtin_amdgcn_sched_barrier(0)
    Unit cur, nxt; int ui = 0;
    if (!S.next(0, cur)) return;
    f32x4 acc[2][2][4][2];
#pragma unroll
    for (int a = 0; a < 2; ++a)
#pragma unroll
        for (int b = 0; b < 2; ++b)
#pragma unroll
            for (int m = 0; m < 4; ++m)
#pragma unroll
                for (int n = 0; n < 2; ++n) acc[a][b][m][n] = (f32x4){0.f, 0.f, 0.f, 0.f};
    bf16x8 At[4][2], B0[2][2], B1[2][2];
    const char* cA = (const char*)g.A + (size_t)cur.pm * tstep; const char* cB = (const char*)g.Bt + (size_t)cur.pn * tstep;
    S.a_ready(cur);
    if constexpr (SP2) {
        PG8_STAGE(PG8_SB(0, 0), cB, voffB); PG8_STAGE(PG8_SB(0, 1), cB + hstep, voffB); PG8_STAGE(PG8_SA(0, 0), cA, voffA); PG8_STAGE(PG8_SA(0, 1), cA + hstep, voffA);
        if (wr == 1) PG8_BAR;
        PG8_WAIT_V(2); PG8_BAR;
        PG8_STAGE(PG8_SB(1, 0), cB + kstep, voffB); PG8_STAGE(PG8_SA(1, 0), cA + kstep, voffA); PG8_STAGE(PG8_SB(1, 1), cB + hstep + kstep, voffB);
        PG8_WAIT_V(6); PG8_BAR;
    } else {
        PG8_STAGE(PG8_SB(0, 0), cB, voffB); PG8_STAGE(PG8_SA(0, 0), cA, voffA); PG8_STAGE(PG8_SB(0, 1), cB + hstep, voffB); PG8_STAGE(PG8_SA(0, 1), cA + hstep, voffA);
        if (wr == 1) PG8_BAR;
        PG8_WAIT_V(4); PG8_BAR;
        PG8_STAGE(PG8_SB(1, 0), cB + kstep, voffB); PG8_STAGE(PG8_SA(1, 0), cA + kstep, voffA); PG8_STAGE(PG8_SB(1, 1), cB + hstep + kstep, voffB);
        PG8_WAIT_V(6); PG8_BAR;
    }
    for (;;) {
        const bool has_next = S.next(ui + 1, nxt);
        const char* nA = has_next ? (const char*)g.A + (size_t)nxt.pm * tstep : cA; const char* nB = has_next ? (const char*)g.Bt + (size_t)nxt.pn * tstep : cB;
        for (int t = 0; t < nt; t += 2) {
            const bool last = (t == nt - 2);
            const char* a1 = cA + (size_t)(t + 1) * kstep;
            const char* a2 = last ? nA : cA + (size_t)(t + 2) * kstep; const char* b2 = last ? nB : cB + (size_t)(t + 2) * kstep;
            const char* a3 = a2 + kstep; const char* b3 = b2 + kstep;
            if (last && has_next) S.a_ready(nxt);
            if constexpr (SP2) {
            PG8_LDB(B0, 0, 0); PG8_LDB(B1, 0, 1); PG8_SCHED; PG8_LDA(At, 0, 0); PG8_STAGE(PG8_SA(1, 1), a1 + hstep, voffA);
            PG8_WAIT_V(8); PG8_WAIT_L(0); PG8_BAR; PG8_MMA(0, 0, At, B0); PG8_MMA(0, 1, At, B1); PG8_BAR; PG8_SCHED;
            PG8_LDA(At, 0, 1); PG8_STAGE(PG8_SB(0, 0), b2, voffB); PG8_STAGE(PG8_SB(0, 1), b2 + hstep, voffB); PG8_STAGE(PG8_SA(0, 0), a2, voffA);
            PG8_WAIT_V(8); PG8_WAIT_L(0); PG8_BAR; PG8_MMA(1, 0, At, B0); PG8_MMA(1, 1, At, B1); PG8_BAR; PG8_SCHED;
            PG8_LDB(B0, 1, 0); PG8_LDB(B1, 1, 1); PG8_SCHED; PG8_LDA(At, 1, 0); PG8_STAGE(PG8_SA(0, 1), a2 + hstep, voffA);
            PG8_WAIT_V(8); PG8_WAIT_L(0); PG8_BAR; PG8_MMA(0, 0, At, B0); PG8_MMA(0, 1, At, B1); PG8_BAR; PG8_SCHED;
            PG8_LDA(At, 1, 1); PG8_STAGE(PG8_SB(1, 0), b3, voffB); PG8_STAGE(PG8_SB(1, 1), b3 + hstep, voffB); PG8_STAGE(PG8_SA(1, 0), a3, voffA);
            PG8_WAIT_V(8); PG8_WAIT_L(0); PG8_BAR; PG8_MMA(1, 0, At, B0); PG8_MMA(1, 1, At, B1); PG8_BAR; PG8_SCHED;
            } else {
            PG8_LDB(B0, 0, 0); PG8_SCHED; PG8_LDA(At, 0, 0); PG8_STAGE(PG8_SA(1, 1), a1 + hstep, voffA);
            PG8_WAIT_L(8); PG8_BAR; PG8_WAIT_L(0); PG8_MMA(0, 0, At, B0); PG8_BAR; PG8_SCHED;
            PG8_LDB(B1, 0, 1); PG8_STAGE(PG8_SB(0, 0), b2, voffB);
            PG8_BAR; PG8_WAIT_L(0); PG8_MMA(0, 1, At, B1); PG8_BAR;
            PG8_LDA(At, 0, 1); PG8_STAGE(PG8_SA(0, 0), a2, voffA);
            PG8_BAR; PG8_WAIT_L(0); PG8_MMA(1, 0, At, B0); PG8_BAR; PG8_SCHED;
            PG8_STAGE(PG8_SB(0, 1), b2 + hstep, voffB);
            PG8_WAIT_V(6); PG8_BAR; PG8_MMA(1, 1, At, B1); PG8_BAR;
            PG8_LDB(B0, 1, 0); PG8_SCHED; PG8_LDA(At, 1, 0); PG8_STAGE(PG8_SA(0, 1), a2 + hstep, voffA);
            PG8_WAIT_L(8); PG8_BAR; PG8_WAIT_L(0); PG8_MMA(0, 0, At, B0); PG8_BAR; PG8_SCHED;
            PG8_LDB(B1, 1, 1); PG8_STAGE(PG8_SB(1, 0), b3, voffB);
            PG8_BAR; PG8_WAIT_L(0); PG8_MMA(0, 1, At, B1); PG8_BAR;
            PG8_LDA(At, 1, 1); PG8_STAGE(PG8_SA(1, 0), a3, voffA);
            PG8_BAR; PG8_WAIT_L(0); PG8_MMA(1, 0, At, B0); PG8_BAR; PG8_SCHED;
            PG8_STAGE(PG8_SB(1, 1), b3 + hstep, voffB);
            PG8_WAIT_V(6); PG8_BAR; PG8_MMA(1, 1, At, B1); PG8_BAR;
            }
        }
        if constexpr (ALIGN_EPI) { if (wr == 0) PG8_BAR; }
        if constexpr (!Epi::AFTER_DRAIN) { E(acc, cur, wr, wc, fr, fq); S.done(cur); }
        if (!has_next) break;
#pragma unroll
        for (int a = 0; a < 2; ++a)
#pragma unroll
            for (int b = 0; b < 2; ++b)
#pragma unroll
                for (int m = 0; m < 4; ++m)
#pragma unroll
                    for (int n = 0; n < 2; ++n) acc[a][b][m][n] = (f32x4){0.f, 0.f, 0.f, 0.f};
        cur = nxt; cA = nA; cB = nB; ++ui;
        if constexpr (ALIGN_EPI) { if (wr == 1) PG8_BAR; }
    }
    PG8_WAIT_V(0);
    if constexpr (!ALIGN_EPI) { if (wr == 0) PG8_BAR; }
    PG8_BAR;
    if constexpr (Epi::AFTER_DRAIN) { E.fused(acc, cur, wr, wc, fr, fq, lds, wid, lane); S.done(cur); }
#undef PG8_SA
#undef PG8_SB
#undef PG8_STAGE
#undef PG8_LDA
#undef PG8_LDB
#undef PG8_MMA
#undef PG8_WAIT_V
#undef PG8_WAIT_L
#undef PG8_BAR
#undef PG8_SCHED
}
}
constexpr int BATCH = 16, SEQ = 2048, D = 1024, M = BATCH * SEQ, DFF = 2816, NQKV = 3072;
constexpr float LN_EPS = 1e-5f, SUBLN_EPS = 1e-5f, LOG2E = 1.4426950408889634f;
constexpr float DN_ALPHA = 1.4142135623730951f;
constexpr float LAMBDA_INIT = 0.2f;
constexpr float QSCALE = 0.125f * LOG2E;
constexpr int NWAVES = 8, NTHREADS = 512;
constexpr size_t MiB = 1u << 20;
constexpr size_t WS_ROPE = 1 * MiB;
constexpr size_t WS_WQKVA = 2 * MiB, WS_WOA = 8 * MiB, WS_W1A = 10 * MiB, WS_W2A = 22 * MiB, WS_WKVQ = 28 * MiB, WS_WOB = 34 * MiB, WS_W1B = 36 * MiB, WS_W2B = 48 * MiB;
constexpr size_t WS_XB = 64 * MiB;
constexpr size_t WS_QKV = 128 * MiB;
constexpr size_t WS_H = 128 * MiB;
constexpr size_t WS_ATT = 320 * MiB;
constexpr size_t WS_Y = 384 * MiB, WS_END = 512 * MiB;
constexpr int LDS_BYTES = 147456;

#define LAS __attribute__((address_space(3)))
typedef unsigned short bf16;
typedef short bf16x8 __attribute__((ext_vector_type(8)));
typedef short s16x4 __attribute__((ext_vector_type(4)));
typedef short v4i16_t __attribute__((ext_vector_type(4)));
typedef float f32x4 __attribute__((ext_vector_type(4)));
typedef float f32x16 __attribute__((ext_vector_type(16)));
typedef unsigned u32x4 __attribute__((ext_vector_type(4)));
typedef unsigned u32x2 __attribute__((ext_vector_type(2)));

__device__ __forceinline__ unsigned pk2(float lo, float hi) { return pg8::cvt_pk_bf16(lo, hi); }
__device__ __forceinline__ float wave_sum(float v) {
#pragma unroll
    for (int o = 1; o < 64; o <<= 1) v += __shfl_xor(v, o);
    return v;
}
__device__ __forceinline__ int dest_row(int map, int n0) {
    if (map == 1) { if (n0 >= 2048) return n0; const int p = n0 >> 8, w = (n0 >> 6) & 3, b = (n0 >> 5) & 1; return (p << 8) + (b << 7) + (w << 5); }
    if (map == 2) { const int up = n0 >= DFF ? 1 : 0; const int nn = up ? n0 - DFF : n0; return ((nn >> 7) << 8) + (up << 7) + (nn & 127); }
    return n0;
}
__device__ __forceinline__ void p0_transpose_item(const float* W, int K, int N, bf16* WT, int row_off, int map, LAS float* scr, int item, int lane) {
    const int nblk = N / 32, kb = item / nblk, nb = item % nblk, k0 = 64 * kb, n0 = 32 * nb;
#pragma unroll 8
    for (int i = 0; i < 32; ++i) { const int kk = 2 * i + (lane >> 5); scr[kk * 33 + (lane & 31)] = W[(size_t)(k0 + kk) * N + n0 + (lane & 31)]; }
    asm volatile("s_waitcnt lgkmcnt(0)" ::: "memory");
    const int c = lane & 7; const int drow = row_off + dest_row(map, n0);
#pragma unroll
    for (int j = 0; j < 4; ++j) { const int n = (lane >> 3) + 8 * j; const LAS float* s = scr + (8 * c) * 33 + n;
        u32x4 o; o.x = pk2(s[0 * 33], s[1 * 33]); o.y = pk2(s[2 * 33], s[3 * 33]); o.z = pk2(s[4 * 33], s[5 * 33]); o.w = pk2(s[6 * 33], s[7 * 33]);
        *(u32x4*)(WT + (size_t)(drow + n) * K + k0 + 8 * c) = o; }
    asm volatile("s_waitcnt lgkmcnt(0)" ::: "memory");
}
__device__ __forceinline__ void ln_phase(const float* Y, const float* g, const float* bt, float* outf, bf16* outb, int gw, int NGW, int lane) {
    f32x4 gg[4], bb[4];
#pragma unroll
    for (int j = 0; j < 4; ++j) { gg[j] = ((const f32x4*)g)[lane + 64 * j]; bb[j] = ((const f32x4*)bt)[lane + 64 * j]; }
    for (int m = gw; m < M; m += NGW) {
        const f32x4* xr = (const f32x4*)(Y + (size_t)m * D) + lane;
        f32x4 v[4]; float s = 0.f;
#pragma unroll
        for (int j = 0; j < 4; ++j) { v[j] = xr[64 * j]; s += (v[j].x + v[j].y) + (v[j].z + v[j].w); }
        const float mean = wave_sum(s) * (1.f / D); float s2 = 0.f;
#pragma unroll
        for (int j = 0; j < 4; ++j) { v[j] = v[j] - mean; s2 += (v[j].x * v[j].x + v[j].y * v[j].y) + (v[j].z * v[j].z + v[j].w * v[j].w); }
        const float rstd = 1.f / sqrtf(wave_sum(s2) * (1.f / D) + LN_EPS);
        f32x4* of = (f32x4*)(outf + (size_t)m * D) + lane;
#pragma unroll
        for (int j = 0; j < 4; ++j) { const f32x4 o = v[j] * rstd * gg[j] + bb[j]; of[64 * j] = o;
            if (outb) { u32x2 w; w.x = pk2(o.x, o.y); w.y = pk2(o.z, o.w); ((u32x2*)(outb + (size_t)m * D))[lane + 64 * j] = w; } }
    }
}
namespace att {
constexpr int KP = 272, VP = 320, KT_B = 64 * KP, VT_B = 64 * VP, ABUF = KT_B + VT_B;
constexpr int TBL_OFF = 2 * ABUF;
constexpr int ROWB = NQKV * 2;
__device__ __forceinline__ int crow(int r, int h) { return (r & 3) + 8 * (r >> 2) + 4 * h; }
__device__ __forceinline__ s16x4 vtr(const LAS char* p) { return __builtin_bit_cast(s16x4, __builtin_amdgcn_ds_read_tr16_b64_v4i16((LAS v4i16_t*)p)); }
#define MFMA32(a, b, c) __builtin_amdgcn_mfma_f32_32x32x16_bf16((a), (b), (c), 0, 0, 0)
template <int NE, bool BIAS>
__device__ __forceinline__ void attn_tile(const LAS char* kb, const LAS char* vb, const bf16x8 (&qf)[4], f32x16 (&o)[NE], float& m_run, float& l_run, int lane,
                                          const LAS float* tbl, int bias_base, bool bias_uniform) {
    const int r32 = lane & 31, h = lane >> 5;
    f32x16 p0, p1;
#pragma unroll
    for (int r = 0; r < 16; ++r) { p0[r] = 0.f; p1[r] = 0.f; }
    const LAS char* kp = kb + r32 * KP + h * 16;
#pragma unroll
    for (int s = 0; s < 4; ++s) {
        const bf16x8 a0 = *(const LAS bf16x8*)(kp + s * 32);
        const bf16x8 a1 = *(const LAS bf16x8*)(kp + 32 * KP + s * 32);
        p0 = MFMA32(a0, qf[s], p0); p1 = MFMA32(a1, qf[s], p1);
    }
    if (BIAS) {
        if (bias_uniform) { const float c = tbl[0];
#pragma unroll
            for (int r = 0; r < 16; ++r) { p0[r] += c; p1[r] += c; }
        } else {
#pragma unroll
            for (int r = 0; r < 16; ++r) { const int i0 = bias_base + crow(r, h), i1 = i0 + 32; p0[r] += tbl[i0 < 0 ? 0 : i0]; p1[r] += tbl[i1 < 0 ? 0 : i1]; }
        }
    }
    float tm = fmaxf(p0[0], p1[0]);
#pragma unroll
    for (int r = 1; r < 16; ++r) tm = fmaxf(tm, fmaxf(p0[r], p1[r]));
    tm = fmaxf(tm, __shfl_xor(tm, 32));
    if (__any(tm > m_run + 8.0f)) {
        const float mn = fmaxf(m_run, tm), al = __builtin_amdgcn_exp2f(m_run - mn);
        l_run *= al; m_run = mn;
#pragma unroll
        for (int c = 0; c < NE; ++c)
#pragma unroll
            for (int r = 0; r < 16; ++r) o[c][r] *= al;
    }
    float sum = 0.f;
#pragma unroll
    for (int r = 0; r < 16; ++r) { p0[r] = __builtin_amdgcn_exp2f(p0[r] - m_run); p1[r] = __builtin_amdgcn_exp2f(p1[r] - m_run); sum += p0[r] + p1[r]; }
    l_run += sum;
    bf16x8 pb[4];
#pragma unroll
    for (int s = 0; s < 2; ++s) {
        u32x4 w0, w1;
        w0.x = pk2(p0[8 * s + 0], p0[8 * s + 1]); w0.y = pk2(p0[8 * s + 2], p0[8 * s + 3]); w0.z = pk2(p0[8 * s + 4], p0[8 * s + 5]); w0.w = pk2(p0[8 * s + 6], p0[8 * s + 7]);
        w1.x = pk2(p1[8 * s + 0], p1[8 * s + 1]); w1.y = pk2(p1[8 * s + 2], p1[8 * s + 3]); w1.z = pk2(p1[8 * s + 4], p1[8 * s + 5]); w1.w = pk2(p1[8 * s + 6], p1[8 * s + 7]);
        pb[s] = __builtin_bit_cast(bf16x8, w0); pb[2 + s] = __builtin_bit_cast(bf16x8, w1);
    }
    const LAS char* vp = vb + (4 * h + ((lane & 15) >> 2)) * VP + ((lane >> 4) & 1) * 32 + (lane & 3) * 8;
#pragma unroll
    for (int c = 0; c < NE; ++c)
#pragma unroll
        for (int s = 0; s < 4; ++s) {
            const s16x4 lo = vtr(vp + (16 * s) * VP + c * 64), hi = vtr(vp + (16 * s + 8) * VP + c * 64);
            const bf16x8 vf = __builtin_shufflevector(lo, hi, 0, 1, 2, 3, 4, 5, 6, 7);
            o[c] = MFMA32(vf, pb[s], o[c]);
        }
}
struct TileRegs { u32x4 k0, k1, v0, v1; };
__device__ __forceinline__ void tile_load(TileRegs& R, const char* kg, const char* vg, int t, int tid) {
    const size_t o0 = (size_t)(t * 64 + (tid >> 4)) * ROWB + (tid & 15) * 16, o1 = o0 + (size_t)32 * ROWB;
    R.k0 = *(const u32x4*)(kg + o0); R.k1 = *(const u32x4*)(kg + o1); R.v0 = *(const u32x4*)(vg + o0); R.v1 = *(const u32x4*)(vg + o1);
}
__device__ __forceinline__ void tile_store(const TileRegs& R, LAS char* buf, int tid) {
    const int row = tid >> 4, ch = tid & 15;
    *(LAS u32x4*)(buf + row * KP + ch * 16) = R.k0; *(LAS u32x4*)(buf + (row + 32) * KP + ch * 16) = R.k1;
    *(LAS u32x4*)(buf + KT_B + row * VP + ch * 16) = R.v0; *(LAS u32x4*)(buf + KT_B + (row + 32) * VP + ch * 16) = R.v1;
}
__device__ __forceinline__ void attnA_unit(LAS char* lds, const bf16* QKV, bf16* ATT, int b, int h, int qb, float lam, const float* gsub) {
    const int tid = threadIdx.x, lane = tid & 63, wid = __builtin_amdgcn_readfirstlane(tid >> 6), map = wid >> 2, wq = wid & 3, r32 = lane & 31, hh = lane >> 5;
    const int q0 = qb * 128; const size_t row0 = (size_t)b * SEQ;
    const int NT = q0 / 64 + 2, my_nt = q0 / 64 + 1 + (wq >> 1);
    const size_t qrow = row0 + q0 + 32 * wq + r32;
    bf16x8 qf[4];
    { const bf16* qp = QKV + qrow * NQKV + h * 128 + map * 64 + 8 * hh;
#pragma unroll
      for (int s = 0; s < 4; ++s) qf[s] = *(const bf16x8*)(qp + 16 * s); }
    const char* kg = (const char*)(QKV + row0 * NQKV + 1024 + h * 128);
    const char* vg = (const char*)(QKV + row0 * NQKV + 2048 + h * 128);
    f32x16 o[4];
#pragma unroll
    for (int c = 0; c < 4; ++c)
#pragma unroll
        for (int r = 0; r < 16; ++r) o[c][r] = 0.f;
    float m_run = -1e30f, l_run = 0.f;
    TileRegs R;
    tile_load(R, kg, vg, 0, tid); tile_store(R, lds, tid);
    __syncthreads();
    for (int t = 0; t < NT; ++t) {
        LAS char* cur = lds + (t & 1) * ABUF; LAS char* nxt = lds + ((t & 1) ^ 1) * ABUF;
        if (t + 1 < NT) tile_load(R, kg, vg, t + 1, tid);
        if (t < my_nt) attn_tile<4, false>(cur + map * 128, cur + KT_B, qf, o, m_run, l_run, lane, nullptr, 0, false);
        if (t + 1 < NT) tile_store(R, nxt, tid);
        __syncthreads();
    }
    l_run += __shfl_xor(l_run, 32);
    const float inv = 1.0f / l_run;
    LAS float* xb = (LAS float*)lds + wq * 4096 + lane;
    if (map == 1) {
#pragma unroll
        for (int c = 0; c < 4; ++c)
#pragma unroll
            for (int r = 0; r < 16; ++r) xb[(c * 16 + r) * 64] = o[c][r] * inv;
    }
    __syncthreads();
    if (map == 0) {
        float ss = 0.f;
#pragma unroll
        for (int c = 0; c < 4; ++c)
#pragma unroll
            for (int r = 0; r < 16; ++r) { const float v = o[c][r] * inv - lam * xb[(c * 16 + r) * 64]; o[c][r] = v; ss += v * v; }
        ss += __shfl_xor(ss, 32);
        const float rs = (1.0f - LAMBDA_INIT) / sqrtf(ss * (1.0f / 128.0f) + SUBLN_EPS);
        bf16* op = ATT + qrow * D + h * 128 + 4 * hh;
#pragma unroll
        for (int c = 0; c < 4; ++c)
#pragma unroll
            for (int g = 0; g < 4; ++g) { const f32x4 gv = *(const f32x4*)(gsub + 32 * c + 8 * g + 4 * hh);
                u32x2 w; w.x = pk2(o[c][4 * g] * rs * gv[0], o[c][4 * g + 1] * rs * gv[1]); w.y = pk2(o[c][4 * g + 2] * rs * gv[2], o[c][4 * g + 3] * rs * gv[3]);
                *(u32x2*)(op + 32 * c + 8 * g) = w; }
    }
    __syncthreads();
}
__device__ __forceinline__ void attnB_unit(LAS char* lds, const bf16* QKV, bf16* ATT, const float* rel_bias, int b, int hp, int qb) {
    const int tid = threadIdx.x, lane = tid & 63, wid = __builtin_amdgcn_readfirstlane(tid >> 6), hs = wid >> 2, wq = wid & 3, r32 = lane & 31, hh = lane >> 5;
    const int head = 2 * hp + hs, q0 = qb * 128, c0 = qb * 2, cw = c0 + (wq >> 1); const size_t row0 = (size_t)b * SEQ;
    const int t_lo = c0 >= 8 ? c0 - 8 : 0, t_hi = c0 + 1;
    LAS float* tbl_all = (LAS float*)(lds + TBL_OFF);
    for (int i = tid; i < 2 * 513; i += NTHREADS) { const int hx = i >= 513 ? 1 : 0, j = i - 513 * hx; tbl_all[hx * 520 + j] = rel_bias[(size_t)(2 * hp + hx) * 513 + j] * LOG2E; }
    const LAS float* tbl = tbl_all + hs * 520;
    const size_t qrow = row0 + q0 + 32 * wq + r32;
    const int qi = 32 * (wq & 1) + r32;
    bf16x8 qf[4];
    { const bf16* qp = QKV + qrow * NQKV + 2048 + head * 64 + 8 * hh;
#pragma unroll
      for (int s = 0; s < 4; ++s) qf[s] = *(const bf16x8*)(qp + 16 * s); }
    const char* kg = (const char*)(QKV + row0 * NQKV + hp * 128);
    const char* vg = (const char*)(QKV + row0 * NQKV + 1024 + hp * 128);
    f32x16 o[2];
#pragma unroll
    for (int c = 0; c < 2; ++c)
#pragma unroll
        for (int r = 0; r < 16; ++r) o[c][r] = 0.f;
    float m_run = -1e30f, l_run = 0.f;
    TileRegs R;
    tile_load(R, kg, vg, t_lo, tid); tile_store(R, lds + (t_lo & 1) * ABUF, tid);
    __syncthreads();
    for (int t = t_lo; t <= t_hi; ++t) {
        LAS char* cur = lds + (t & 1) * ABUF; LAS char* nxt = lds + ((t & 1) ^ 1) * ABUF;
        if (t + 1 <= t_hi) tile_load(R, kg, vg, t + 1, tid);
        const int d = t - cw;
        if (d <= 0 && d >= -8) attn_tile<2, true>(cur + hs * 128, cur + KT_B + hs * 128, qf, o, m_run, l_run, lane, tbl, 64 * d - qi + 256, d <= -5);
        if (t + 1 <= t_hi) tile_store(R, nxt, tid);
        __syncthreads();
    }
    l_run += __shfl_xor(l_run, 32);
    const float inv = 1.0f / l_run;
    bf16* op = ATT + qrow * D + head * 64 + 4 * hh;
#pragma unroll
    for (int c = 0; c < 2; ++c)
#pragma unroll
        for (int g = 0; g < 4; ++g) { u32x2 w; w.x = pk2(o[c][4 * g] * inv, o[c][4 * g + 1] * inv); w.y = pk2(o[c][4 * g + 2] * inv, o[c][4 * g + 3] * inv);
            *(u32x2*)(op + 32 * c + 8 * g) = w; }
}
}

struct Args { const float* in[13]; float* out; unsigned char* ws; float inv_freq[32]; int ph_lo, ph_hi; };
constexpr int N_PHASES = 15;

__global__ void __launch_bounds__(NTHREADS, 2) yoco_fwd(Args args) {
    extern __shared__ __attribute__((aligned(16))) unsigned char lds_raw[];
    LAS unsigned char* lds = (LAS unsigned char*)lds_raw;
    const int tid = threadIdx.x, lane = tid & 63, wave = __builtin_amdgcn_readfirstlane(tid >> 6);
    const int G = gridDim.x, bx = blockIdx.x;
    const int vcu = (G % 8 == 0) ? (bx % 8) * (G / 8) + bx / 8 : bx;
    const int gw = vcu * NWAVES + wave, NGW = G * NWAVES;
    unsigned char* ws = args.ws;
    const float* x_in = args.in[0]; const float* a_w_qkv = args.in[1]; const float* a_lambda = args.in[2]; const float* a_subln_g = args.in[3]; const float* a_w_o = args.in[4];
    const float* kv_w = args.in[5]; const float* b_w_q = args.in[6]; const float* b_rel_bias = args.in[7]; const float* b_w_o = args.in[8];
    const float* ln_g = args.in[9]; const float* ln_b = args.in[10]; const float* ffn_w_in = args.in[11]; const float* ffn_w_out = args.in[12];
    float* out = args.out;
    float* rope = (float*)(ws + WS_ROPE);
    bf16* WqkvA = (bf16*)(ws + WS_WQKVA); bf16* WoA = (bf16*)(ws + WS_WOA); bf16* W1A = (bf16*)(ws + WS_W1A); bf16* W2A = (bf16*)(ws + WS_W2A);
    bf16* Wkvq = (bf16*)(ws + WS_WKVQ); bf16* WoB = (bf16*)(ws + WS_WOB); bf16* W1B = (bf16*)(ws + WS_W1B); bf16* W2B = (bf16*)(ws + WS_W2B);
    bf16* XB = (bf16*)(ws + WS_XB); bf16* QKV = (bf16*)(ws + WS_QKV); bf16* HB = (bf16*)(ws + WS_H); bf16* ATT = (bf16*)(ws + WS_ATT); float* Y = (float*)(ws + WS_Y);
    const int lo = args.ph_lo, hi = args.ph_hi;
#define IN(k) (lo <= (k) && (k) < hi)
#if MK_ONE_LAUNCH
#define SEAM(k) do { if (IN(k) && IN((k) + 1)) { cg::this_grid().sync(); } } while (0)
#else
#define SEAM(k) do { } while (0)
#endif
    if (IN(0)) {
        LAS float* scr = (LAS float*)(lds + wave * 16384);
        constexpr int I_QKV = (D / 64) * (NQKV / 32), I_O = (D / 64) * (D / 32), I_1 = (D / 64) * (2 * DFF / 32), I_2 = (DFF / 64) * (D / 32), I_KV = (D / 64) * (2 * D / 32);
        constexpr int NITEMS = I_QKV + I_O + I_1 + I_2 + I_KV + I_O + I_O + I_1 + I_2;
        for (int it = gw; it < NITEMS; it += NGW) {
            int r = it;
            if (r < I_QKV) { p0_transpose_item(a_w_qkv, D, NQKV, WqkvA, 0, 1, scr, r, lane); continue; } r -= I_QKV;
            if (r < I_O) { p0_transpose_item(a_w_o, D, D, WoA, 0, 0, scr, r, lane); continue; } r -= I_O;
            if (r < I_1) { p0_transpose_item(ffn_w_in, D, 2 * DFF, W1A, 0, 2, scr, r, lane); continue; } r -= I_1;
            if (r < I_2) { p0_transpose_item(ffn_w_out, DFF, D, W2A, 0, 0, scr, r, lane); continue; } r -= I_2;
            if (r < I_KV) { p0_transpose_item(kv_w, D, 2 * D, Wkvq, 0, 0, scr, r, lane); continue; } r -= I_KV;
            if (r < I_O) { p0_transpose_item(b_w_q, D, D, Wkvq, 2 * D, 0, scr, r, lane); continue; } r -= I_O;
            if (r < I_O) { p0_transpose_item(b_w_o, D, D, WoB, 0, 0, scr, r, lane); continue; } r -= I_O;
            if (r < I_1) { p0_transpose_item(ffn_w_in + (size_t)D * 2 * DFF, D, 2 * DFF, W1B, 0, 2, scr, r, lane); continue; } r -= I_1;
            p0_transpose_item(ffn_w_out + (size_t)DFF * D, DFF, D, W2B, 0, 0, scr, r, lane);
        }
        for (int m = gw; m < M; m += NGW) {
            const f32x4* xr = (const f32x4*)(x_in + (size_t)m * D) + lane; u32x2* o8 = (u32x2*)(XB + (size_t)m * D) + lane;
#pragma unroll
            for (int j = 0; j < 4; ++j) { const f32x4 v = xr[64 * j]; u32x2 w; w.x = pk2(v.x, v.y); w.y = pk2(v.z, v.w); o8[64 * j] = w; }
        }
        for (int i = bx * NTHREADS + tid; i < SEQ * 32; i += G * NTHREADS) {
            const int pos = i >> 5, k = i & 31; const float ang = (float)pos * args.inv_freq[k];
            double rev = (double)ang * 0.15915494309189535; rev -= __builtin_rint(rev);
            const float rf = (float)rev; rope[2 * i] = __builtin_amdgcn_cosf(rf); rope[2 * i + 1] = __builtin_amdgcn_sinf(rf);
        }
    }
    SEAM(0);
    if (IN(1)) { pg8::Gemm g{XB, WqkvA, M, NQKV, D}; pg8::StaticOrder S; S.init(M, NQKV, G, bx); pg8::EpiQkvRope E{QKV, NQKV, rope, QSCALE};
        pg8::gemm_phase<pg8::EpiQkvRope, pg8::StaticOrder, true, true>(lds, g, S, E); }
    SEAM(1);
    if (IN(2)) {
        const float pa = a_lambda[lane] * a_lambda[64 + lane], pb = a_lambda[128 + lane] * a_lambda[192 + lane];
        const float lam = expf(wave_sum(pa)) - expf(wave_sum(pb)) + LAMBDA_INIT;
        for (int u = vcu; u < 2048; u += G) { const int v = u & 255, j = u >> 8, bh = v >> 1, half = v & 1, i = 4 * half + (j >> 1), qb = (j & 1) ? 15 - i : i;
            att::attnA_unit((LAS char*)lds, QKV, ATT, bh >> 3, bh & 7, qb, lam, a_subln_g); }
    }
    SEAM(2);
    if (IN(3)) { pg8::Gemm g{ATT, WoA, M, D, D}; pg8::StaticOrder S; S.init(M, D, G, bx); pg8::EpiResid E{x_in, Y, D, DN_ALPHA};
        pg8::gemm_phase<pg8::EpiResid, pg8::StaticOrder, true, true>(lds, g, S, E); }
    SEAM(3);
    if (IN(4)) ln_phase(Y, ln_g, ln_b, out, XB, gw, NGW, lane);
    SEAM(4);
    if (IN(5)) { pg8::Gemm g{XB, W1A, M, 2 * DFF, D}; pg8::StaticOrder S; S.init(M, 2 * DFF, G, bx); pg8::EpiSwiglu E{HB, DFF};
        pg8::gemm_phase<pg8::EpiSwiglu, pg8::StaticOrder, true, true>(lds, g, S, E); }
    SEAM(5);
    if (IN(6)) { pg8::Gemm g{HB, W2A, M, D, DFF}; pg8::StaticOrder S; S.init(M, D, G, bx); pg8::EpiResid E{out, Y, D, DN_ALPHA};
        pg8::gemm_phase<pg8::EpiResid, pg8::StaticOrder, true, true>(lds, g, S, E); }
    SEAM(6);
    if (IN(7)) ln_phase(Y, ln_g + D, ln_b + D, out, XB, gw, NGW, lane);
    SEAM(7);
    if (IN(8)) { pg8::Gemm g{XB, Wkvq, M, NQKV, D}; pg8::StaticOrder S; S.init(M, NQKV, G, bx); pg8::EpiPlain E{QKV, NQKV, 2048, QSCALE};
        pg8::gemm_phase<pg8::EpiPlain, pg8::StaticOrder, true, true>(lds, g, S, E); }
    SEAM(8);
    if (IN(9)) {
        for (int u = vcu; u < 2048; u += G) { const int v = u & 255, j = u >> 8, bhp = v >> 1, half = v & 1;
            const int qb = half == 0 ? (j == 0 ? 0 : (j == 1 ? 3 : j + 2)) : (j == 0 ? 1 : (j == 1 ? 2 : j + 8));
            att::attnB_unit((LAS char*)lds, QKV, ATT, b_rel_bias, bhp >> 3, bhp & 7, qb); }
    }
    SEAM(9);
    if (IN(10)) { pg8::Gemm g{ATT, WoB, M, D, D}; pg8::StaticOrder S; S.init(M, D, G, bx); pg8::EpiResid E{out, Y, D, DN_ALPHA};
        pg8::gemm_phase<pg8::EpiResid, pg8::StaticOrder, true, true>(lds, g, S, E); }
    SEAM(10);
    if (IN(11)) ln_phase(Y, ln_g + 2 * D, ln_b + 2 * D, out, XB, gw, NGW, lane);
    SEAM(11);
    if (IN(12)) { pg8::Gemm g{XB, W1B, M, 2 * DFF, D}; pg8::StaticOrder S; S.init(M, 2 * DFF, G, bx); pg8::EpiSwiglu E{HB, DFF};
        pg8::gemm_phase<pg8::EpiSwiglu, pg8::StaticOrder, true, true>(lds, g, S, E); }
    SEAM(12);
    if (IN(13)) { pg8::Gemm g{HB, W2B, M, D, DFF}; pg8::StaticOrder S; S.init(M, D, G, bx); pg8::EpiResid E{out, Y, D, DN_ALPHA};
        pg8::gemm_phase<pg8::EpiResid, pg8::StaticOrder, true, true>(lds, g, S, E); }
    SEAM(13);
    if (IN(14)) ln_phase(Y, ln_g + 3 * D, ln_b + 3 * D, out, nullptr, gw, NGW, lane);
#undef IN
#undef SEAM
}

extern "C" void kernel_launch(void* const* d_in, const int* in_sizes, int n_in, void* d_out, int out_size, void* d_ws, size_t ws_size, hipStream_t stream) {
    static int grid = 0;
    if (grid == 0) {
        if (n_in != 13 || in_sizes[0] != M * D || out_size != M * D || ws_size < WS_END) { fprintf(stderr, "kernel_launch: unexpected shapes (n_in %d, in0 %d, out %d, ws %zu)\n", n_in, n_in > 0 ? in_sizes[0] : -1, out_size, ws_size); grid = -1; return; }
        int dev = 0, cus = 0, per_cu = 0;
        if (hipGetDevice(&dev) != hipSuccess || hipDeviceGetAttribute(&cus, hipDeviceAttributeMultiprocessorCount, dev) != hipSuccess) { grid = -1; return; }
        if (hipFuncSetAttribute((const void*)yoco_fwd, hipFuncAttributeMaxDynamicSharedMemorySize, LDS_BYTES) != hipSuccess) { fprintf(stderr, "kernel_launch: hipFuncSetAttribute failed\n"); grid = -1; return; }
        if (hipOccupancyMaxActiveBlocksPerMultiprocessor(&per_cu, (const void*)yoco_fwd, NTHREADS, LDS_BYTES) != hipSuccess || per_cu < 1) { fprintf(stderr, "kernel_launch: occupancy query gave %d\n", per_cu); per_cu = 1; }
        (void)hipGetLastError();
        grid = cus * per_cu;
        fprintf(stderr, "kernel_launch: grid %d (cus %d x %d)\n", grid, cus, per_cu);
    }
    if (grid < 0) return;
    Args a{};
    for (int i = 0; i < 13; ++i) a.in[i] = (const float*)d_in[i];
    a.out = (float*)d_out; a.ws = (unsigned char*)d_ws;
    for (int i = 0; i < 32; ++i) a.inv_freq[i] = (float)pow(10000.0, -(double)i / 32.0);
#if MK_ONE_LAUNCH
    a.ph_lo = 0; a.ph_hi = N_PHASES;
    void* kargs[] = {&a};
    hipError_t e = hipLaunchCooperativeKernel((const void*)yoco_fwd, dim3(grid), dim3(NTHREADS), kargs, LDS_BYTES, stream);
    if (e != hipSuccess) fprintf(stderr, "kernel_launch: cooperative launch failed: %s (grid %d)\n", hipGetErrorString(e), grid);
#else
    for (int p = 0; p < N_PHASES; ++p) { a.ph_lo = p; a.ph_hi = p + 1; hipLaunchKernelGGL(yoco_fwd, dim3(grid), dim3(NTHREADS), LDS_BYTES, stream, a); }
#endif
}
```
